# Optimizing an MI355X kernel written in HIP

```python
import math
import jax, jax.numpy as jnp
from jax import lax
import numpy as np

D_MODEL = 1024
BATCH = 8
SEQ = 2048
DEPTH = 2

N_A_LAYERS = DEPTH // 2
N_B_LAYERS = DEPTH - N_A_LAYERS
POOL_WINDOWS = (2, 4, 8, 16)
N_POOL_GROUPS = len(POOL_WINDOWS)
POOL_GROUP_DIM = D_MODEL // N_POOL_GROUPS
HEAD_DIM = 64
N_HEADS = D_MODEL // HEAD_DIM
MOBA_BLOCK = 256
MOBA_TOP_K = 3
QUERY_CHUNK = 16
D_FF = 4 * D_MODEL
ROPE_THETA = 10000.0
LN_EPS = 1e-5
DEEPNORM_ALPHA = (2.0 * DEPTH) ** 0.25
DEEPNORM_BETA = (8.0 * DEPTH) ** -0.25

kernel_name = "yoco_pool_moba_hybrid"


def layer_norm(x, g, b):
    xf = x.astype(jnp.float32)
    mu = jnp.mean(xf, axis=-1, keepdims=True)
    var = jnp.mean(jnp.square(xf - mu), axis=-1, keepdims=True)
    return ((xf - mu) * lax.rsqrt(var + LN_EPS) * g + b).astype(x.dtype)


def deepnorm_residual(x, y, g, b):
    return layer_norm(DEEPNORM_ALPHA * x + y, g, b)


def sq_relu_mlp(x, w1, w2):
    h = jnp.square(jax.nn.relu(x @ w1))
    return h @ w2


def rope(x):
    s, dh = x.shape[1], x.shape[-1]
    half = dh // 2
    inv_freq = ROPE_THETA ** (-jnp.arange(half, dtype=jnp.float32) * 2.0 / dh)
    ang = jnp.arange(s, dtype=jnp.float32)[:, None] * inv_freq[None, :]
    cos = jnp.cos(ang)[None, :, None, :].astype(x.dtype)
    sin = jnp.sin(ang)[None, :, None, :].astype(x.dtype)
    x1, x2 = x[..., :half], x[..., half:]
    return jnp.concatenate([x1 * cos - x2 * sin, x2 * cos + x1 * sin], axis=-1)


def pool_mixer(x, w_pool, scale):
    b, s, d = x.shape
    cs = jnp.cumsum(x.astype(jnp.float32), axis=1)
    cs0 = jnp.pad(cs, ((0, 0), (1, 0), (0, 0)))
    t = jnp.arange(s)
    groups = []
    for g, w in enumerate(POOL_WINDOWS):
        csg = cs0[:, :, g * POOL_GROUP_DIM:(g + 1) * POOL_GROUP_DIM]
        upper = csg[:, 1:]
        lower = jnp.pad(csg, ((0, 0), (w, 0), (0, 0)))[:, 1:s + 1]
        count = jnp.minimum(t + 1, w).astype(jnp.float32)[None, :, None]
        xg = x[:, :, g * POOL_GROUP_DIM:(g + 1) * POOL_GROUP_DIM].astype(jnp.float32)
        groups.append((upper - lower) / count - xg)
    pooled = jnp.stack(groups, axis=2).astype(x.dtype)
    y = jnp.einsum('bsgc,gce->bsge', pooled, w_pool).reshape(b, s, d)
    return y * scale


def shared_kv(x, w_kv):
    b, s, d = x.shape
    kv = x @ w_kv
    k = rope(kv[..., :d].reshape(b, s, N_HEADS, HEAD_DIM))
    v = kv[..., d:].reshape(b, s, N_HEADS, HEAD_DIM)
    n_blk = -(-s // MOBA_BLOCK)
    pad = n_blk * MOBA_BLOCK - s
    k = jnp.pad(k, ((0, 0), (0, pad), (0, 0), (0, 0)))
    v = jnp.pad(v, ((0, 0), (0, pad), (0, 0), (0, 0)))
    k_blocks = k.reshape(b, n_blk, MOBA_BLOCK, N_HEADS, HEAD_DIM).transpose(0, 3, 1, 2, 4)
    v_blocks = v.reshape(b, n_blk, MOBA_BLOCK, N_HEADS, HEAD_DIM).transpose(0, 3, 1, 2, 4)
    k_mean = jnp.mean(k_blocks.astype(jnp.float32), axis=3).astype(x.dtype)
    return k_blocks, v_blocks, k_mean


def moba_attention(x, w_q, w_o, k_blocks, v_blocks, k_mean):
    b, s, d = x.shape
    q = rope((x @ w_q).reshape(b, s, N_HEADS, HEAD_DIM)).transpose(0, 2, 1, 3)
    n_blk = k_blocks.shape[2]
    n_sel = min(MOBA_TOP_K, n_blk - 1)
    scale = HEAD_DIM ** -0.5
    bi = jnp.arange(b)[:, None, None, None]
    hi = jnp.arange(N_HEADS)[None, :, None, None]
    span = n_sel * MOBA_BLOCK

    def chunk(c):
        p0 = c * QUERY_CHUNK
        q_c = lax.dynamic_slice_in_dim(q, p0, QUERY_CHUNK, axis=2)
        q_pos = p0 + jnp.arange(QUERY_CHUNK)
        own = p0 // MOBA_BLOCK
        k_own = lax.dynamic_index_in_dim(k_blocks, own, axis=2, keepdims=False)
        v_own = lax.dynamic_index_in_dim(v_blocks, own, axis=2, keepdims=False)
        k_pos = own * MOBA_BLOCK + jnp.arange(MOBA_BLOCK)
        s_own = jnp.einsum('bhqd,bhkd->bhqk', q_c, k_own).astype(jnp.float32) * scale
        s_own = jnp.where(k_pos[None, :] <= q_pos[:, None], s_own, -jnp.inf)
        if n_sel > 0:
            gate = jnp.einsum('bhqd,bhnd->bhqn', q_c, k_mean).astype(jnp.float32)
            gate = jnp.where(jnp.arange(n_blk) < own, gate, -jnp.inf)
            _, sel = lax.top_k(gate, n_sel)
            sel_ok = sel < own
            k_sel = k_blocks[bi, hi, sel]
            v_sel = v_blocks[bi, hi, sel]
            s_sel = jnp.einsum('bhqd,bhqnkd->bhqnk', q_c, k_sel).astype(jnp.float32) * scale
            s_sel = jnp.where(sel_ok[..., None], s_sel, -jnp.inf).reshape(b, N_HEADS, QUERY_CHUNK, span)
            p = jax.nn.softmax(jnp.concatenate([s_sel, s_own], axis=-1), axis=-1).astype(v_blocks.dtype)
            p_sel = p[..., :span].reshape(b, N_HEADS, QUERY_CHUNK, n_sel, MOBA_BLOCK)
            o = (jnp.einsum('bhqnk,bhqnkd->bhqd', p_sel, v_sel)
                 + jnp.einsum('bhqk,bhkd->bhqd', p[..., span:], v_own))
        else:
            p = jax.nn.softmax(s_own, axis=-1).astype(v_blocks.dtype)
            o = jnp.einsum('bhqk,bhkd->bhqd', p, v_own)
        return o

    out = lax.map(chunk, jnp.arange(s // QUERY_CHUNK))
    out = out.transpose(1, 0, 3, 2, 4).reshape(b, s, d)
    return out @ w_o


def setup_inputs(seed: int = 0) -> dict:
    key = jax.random.key(seed)
    ks = jax.random.split(key, 12)
    f32 = jnp.float32
    d = D_MODEL
    x = jax.random.normal(ks[0], (BATCH, SEQ, d), f32)
    pool_w = jax.random.normal(ks[1], (N_A_LAYERS, N_POOL_GROUPS, POOL_GROUP_DIM, POOL_GROUP_DIM), f32) * (POOL_GROUP_DIM ** -0.5) * DEEPNORM_BETA
    pool_scale = 1.0 + 0.1 * jax.random.normal(ks[2], (N_A_LAYERS, d), f32)
    mlp_w1 = jax.random.normal(ks[3], (DEPTH, d, D_FF), f32) * (d ** -0.5) * DEEPNORM_BETA
    mlp_w2 = jax.random.normal(ks[4], (DEPTH, D_FF, d), f32) * (D_FF ** -0.5) * DEEPNORM_BETA
    ln_mix_g = 1.0 + 0.05 * jax.random.normal(ks[5], (DEPTH, d), f32)
    ln_mix_b = 0.02 * jax.random.normal(ks[6], (DEPTH, d), f32)
    ln_ffn_g = 1.0 + 0.05 * jax.random.normal(ks[7], (DEPTH, d), f32)
    ln_ffn_b = 0.02 * jax.random.normal(ks[8], (DEPTH, d), f32)
    kv_scale = jnp.concatenate([jnp.ones((d,), f32), jnp.full((d,), DEEPNORM_BETA, f32)])
    w_kv = jax.random.normal(ks[9], (d, 2 * d), f32) * (d ** -0.5) * kv_scale[None, :]
    w_q = jax.random.normal(ks[10], (N_B_LAYERS, d, d), f32) * (d ** -0.5)
    w_o = jax.random.normal(ks[11], (N_B_LAYERS, d, d), f32) * (d ** -0.5) * DEEPNORM_BETA
    return {"x": x, "pool_w": pool_w, "pool_scale": pool_scale, "mlp_w1": mlp_w1, "mlp_w2": mlp_w2,
            "ln_mix_g": ln_mix_g, "ln_mix_b": ln_mix_b, "ln_ffn_g": ln_ffn_g, "ln_ffn_b": ln_ffn_b,
            "w_kv": w_kv, "w_q": w_q, "w_o": w_o}


def reference(x, pool_w, pool_scale, mlp_w1, mlp_w2, ln_mix_g, ln_mix_b, ln_ffn_g, ln_ffn_b, w_kv, w_q, w_o):
    kv_cache = None
    for l in range(DEPTH):
        if l < N_A_LAYERS:
            y = pool_mixer(x, pool_w[l], pool_scale[l])
        else:
            if kv_cache is None:
                kv_cache = shared_kv(x, w_kv)
            k_blocks, v_blocks, k_mean = kv_cache
            j = l - N_A_LAYERS
            y = moba_attention(x, w_q[j], w_o[j], k_blocks, v_blocks, k_mean)
        x = deepnorm_residual(x, y, ln_mix_g[l], ln_mix_b[l])
        x = deepnorm_residual(x, sq_relu_mlp(x, mlp_w1[l], mlp_w2[l]), ln_ffn_g[l], ln_ffn_b[l])
    return x
```

```cpp
#include <hip/hip_runtime.h>
#include <cstdint>
#include <cstdio>

namespace nv {
constexpr int D = 1024, B = 8, S = 2048, M = B * S, FF = 4096, H = 16, HD = 64, NBLK = 8, BLK = 256;
constexpr float ALPHA = 1.4142135623730951f;
constexpr float LN_EPS = 1e-5f;

__global__ void k_pool(const float* __restrict__ x, float* __restrict__ pooled) {
    const size_t idx = (size_t)blockIdx.x * blockDim.x + threadIdx.x;
    if (idx >= (size_t)M * D) return;
    const int c = (int)(idx % D); const int m = (int)(idx / D); const int t = m % S;
    const int g = c / 256; const int w = 2 << g;
    const int cnt = (t + 1 < w) ? (t + 1) : w;
    float s = 0.f;
    for (int i = cnt - 1; i >= 0; --i) s += x[(size_t)(m - i) * D + c];
    pooled[idx] = s / (float)cnt - x[idx];
}

template <int ACT>
__global__ void __launch_bounds__(256) k_gemm(const float* __restrict__ A, int lda, const float* __restrict__ Bm, int ldb, float* __restrict__ C, int ldc, int Mm, int Nn, int Kk) {
    __shared__ float As[16][64 + 4];
    __shared__ float Bs[16][64 + 4];
    const int tx = threadIdx.x % 16, ty = threadIdx.x / 16;
    const int m0 = blockIdx.y * 64, n0 = blockIdx.x * 64;
    float acc[4][4] = {};
    for (int k0 = 0; k0 < Kk; k0 += 16) {
        for (int i = threadIdx.x; i < 64 * 16; i += 256) { const int mm = i / 16, kk = i % 16; As[kk][mm] = A[(size_t)(m0 + mm) * lda + k0 + kk]; }
        for (int i = threadIdx.x; i < 16 * 64; i += 256) { const int kk = i / 64, nn = i % 64; Bs[kk][nn] = Bm[(size_t)(k0 + kk) * ldb + n0 + nn]; }
        __syncthreads();
#pragma unroll
        for (int kk = 0; kk < 16; ++kk) {
            float a[4], b[4];
#pragma unroll
            for (int i = 0; i < 4; ++i) { a[i] = As[kk][ty * 4 + i]; b[i] = Bs[kk][tx * 4 + i]; }
#pragma unroll
            for (int i = 0; i < 4; ++i)
#pragma unroll
                for (int j = 0; j < 4; ++j) acc[i][j] = fmaf(a[i], b[j], acc[i][j]);
        }
        __syncthreads();
    }
#pragma unroll
    for (int i = 0; i < 4; ++i)
#pragma unroll
        for (int j = 0; j < 4; ++j) { float v = acc[i][j]; if (ACT == 1) { v = v > 0.f ? v : 0.f; v = v * v; } C[(size_t)(m0 + ty * 4 + i) * ldc + n0 + tx * 4 + j] = v; }
}

__global__ void __launch_bounds__(256) k_ln(const float* x, const float* __restrict__ y, const float* __restrict__ cs, const float* __restrict__ g, const float* __restrict__ b, float* out) {
    __shared__ float red[8];
    const int m = blockIdx.x, tid = threadIdx.x;
    float v[4]; float s = 0.f;
#pragma unroll
    for (int j = 0; j < 4; ++j) { const int c = tid + 256 * j; float yy = y[(size_t)m * D + c]; if (cs) yy *= cs[c]; v[j] = ALPHA * x[(size_t)m * D + c] + yy; s += v[j]; }
    for (int o = 32; o > 0; o >>= 1) s += __shfl_xor(s, o);
    if ((tid & 63) == 0) red[tid >> 6] = s;
    __syncthreads();
    const float mean = (red[0] + red[1] + red[2] + red[3]) * (1.f / D);
    float q = 0.f;
#pragma unroll
    for (int j = 0; j < 4; ++j) { const float d = v[j] - mean; q += d * d; }
    for (int o = 32; o > 0; o >>= 1) q += __shfl_xor(q, o);
    if ((tid & 63) == 0) red[4 + (tid >> 6)] = q;
    __syncthreads();
    const float var = (red[4] + red[5] + red[6] + red[7]) * (1.f / D);
    const float rstd = 1.0f / sqrtf(var + LN_EPS);
#pragma unroll
    for (int j = 0; j < 4; ++j) { const int c = tid + 256 * j; out[(size_t)m * D + c] = (v[j] - mean) * rstd * g[c] + b[c]; }
}

__global__ void k_rope(float* t, int ld) {
    const size_t idx = (size_t)blockIdx.x * blockDim.x + threadIdx.x;
    if (idx >= (size_t)M * H * 32) return;
    const int i = (int)(idx % 32); const int h = (int)((idx / 32) % H); const int m = (int)(idx / (32 * H));
    const int pos = m % S;
    const float inv_freq = powf(10000.0f, -(float)i * 2.0f / 64.0f);
    const float ang = (float)pos * inv_freq;
    float sn, cs; sincosf(ang, &sn, &cs);
    float* p = t + (size_t)m * ld + h * 64 + i;
    const float x1 = p[0], x2 = p[32];
    p[0] = x1 * cs - x2 * sn; p[32] = x2 * cs + x1 * sn;
}

__global__ void k_kmean(const float* __restrict__ k, int ld, float* __restrict__ kmean) {
    const int c = blockIdx.x * blockDim.x + threadIdx.x; const int bn = blockIdx.y;
    if (c >= D) return;
    float s = 0.f;
    for (int r = 0; r < BLK; ++r) s += k[(size_t)(bn * BLK + r) * ld + c];
    kmean[(size_t)bn * D + c] = s * (1.f / BLK);
}

__global__ void __launch_bounds__(256) k_moba(const float* q, int ldq, const float* __restrict__ k, int ldk, const float* __restrict__ v, int ldv, const float* __restrict__ kmean, float* o, int ldo) {
    __shared__ float qs[4][64];
    __shared__ float ps[4][1024];
    const int wid = threadIdx.x >> 6, lane = threadIdx.x & 63;
    const int h = blockIdx.y; const int m = blockIdx.x * 4 + wid; const int b = m / S, pos = m % S, own = pos / BLK;
    const float qd = q[(size_t)m * ldq + h * 64 + lane];
    qs[wid][lane] = qd;
    float gate[NBLK];
#pragma unroll
    for (int n = 0; n < NBLK; ++n) {
        float gsum = qd * kmean[(size_t)(b * NBLK + n) * D + h * 64 + lane];
        for (int of = 32; of > 0; of >>= 1) gsum += __shfl_xor(gsum, of);
        gate[n] = (n < own) ? gsum : -INFINITY;
    }
    int selmask = 0; int taken = 0;
#pragma unroll
    for (int r = 0; r < 3; ++r) {
        int best = -1; float bv = 0.f;
#pragma unroll
        for (int n = 0; n < NBLK; ++n) { if (!((taken >> n) & 1)) { if (best < 0 || gate[n] > bv) { best = n; bv = gate[n]; } } }
        taken |= 1 << best; if (best < own) selmask |= 1 << best;
    }
    selmask |= 1 << own;
    __syncthreads();
    float mx = -INFINITY;
    float sc[NBLK][4];
#pragma unroll
    for (int n = 0; n < NBLK; ++n) {
#pragma unroll
        for (int j = 0; j < 4; ++j) {
            float s = -INFINITY;
            if ((selmask >> n) & 1) {
                const int kp = n * BLK + lane + 64 * j;
                if (kp <= pos) {
                    const float* kr = k + (size_t)(b * S + kp) * ldk + h * 64;
                    float a = 0.f;
                    for (int d = 0; d < 64; ++d) a = fmaf(qs[wid][d], kr[d], a);
                    s = a * 0.125f;
                }
            }
            sc[n][j] = s; mx = fmaxf(mx, s);
        }
    }
    for (int of = 32; of > 0; of >>= 1) mx = fmaxf(mx, __shfl_xor(mx, of));
    float l = 0.f;
#pragma unroll
    for (int n = 0; n < NBLK; ++n)
#pragma unroll
        for (int j = 0; j < 4; ++j) { const float p = (sc[n][j] == -INFINITY) ? 0.f : expf(sc[n][j] - mx); l += p; sc[n][j] = p; }
    for (int of = 32; of > 0; of >>= 1) l += __shfl_xor(l, of);
    const float rl = 1.f / l;
    float acc = 0.f;
    for (int n = 0; n <= own; ++n) {
        if (!((selmask >> n) & 1)) continue;
#pragma unroll
        for (int j = 0; j < 4; ++j) {
            float p = 0.f;
#pragma unroll
            for (int nn = 0; nn < NBLK; ++nn) if (nn == n) p = sc[nn][j];
            ps[wid][lane + 64 * j] = p;
        }
        __builtin_amdgcn_wave_barrier();
        __builtin_amdgcn_s_waitcnt(0xc07f);
        const int kmax = (n == own) ? (pos - own * BLK + 1) : BLK;
        const float* vr = v + (size_t)(b * S + n * BLK) * ldv + h * 64 + lane;
        for (int kk = 0; kk < kmax; ++kk) acc = fmaf(ps[wid][kk], vr[(size_t)kk * ldv], acc);
        __builtin_amdgcn_wave_barrier();
    }
    o[(size_t)m * ldo + h * 64 + lane] = acc * rl;
}
}

extern "C" void kernel_launch(void* const* d_in, const int* in_sizes, int n_in, void* d_out, int out_size, void* d_ws, size_t ws_size, hipStream_t stream) {
    using namespace nv;
    const float* x = (const float*)d_in[0];
    const float* pool_w = (const float*)d_in[1];
    const float* pool_scale = (const float*)d_in[2];
    const float* w1 = (const float*)d_in[3];
    const float* w2 = (const float*)d_in[4];
    const float* ln_mix_g = (const float*)d_in[5];
    const float* ln_mix_b = (const float*)d_in[6];
    const float* ln_ffn_g = (const float*)d_in[7];
    const float* ln_ffn_b = (const float*)d_in[8];
    const float* w_kv = (const float*)d_in[9];
    const float* w_q = (const float*)d_in[10];
    const float* w_o = (const float*)d_in[11];
    float* out = (float*)d_out;
    float* ws = (float*)d_ws;
    const size_t T = (size_t)M * D;
    float* buf0 = ws;
    float* buf1 = ws + T;
    float* buf2 = ws + 2 * T;
    float* kmean = ws + 3 * T;
    k_pool<<<(unsigned)((T + 255) / 256), 256, 0, stream>>>(x, buf0);
    for (int g = 0; g < 4; ++g)
        k_gemm<0><<<dim3(256 / 64, M / 64), 256, 0, stream>>>(buf0 + g * 256, D, pool_w + (size_t)g * 256 * 256, 256, buf1 + g * 256, D, M, 256, 256);
    k_ln<<<M, 256, 0, stream>>>(x, buf1, pool_scale, ln_mix_g, ln_mix_b, out);
    auto mlp = [&](int l) {
        for (int c = 0; c < 4; ++c) {
            const size_t r0 = (size_t)c * 4096;
            k_gemm<1><<<dim3(FF / 64, 4096 / 64), 256, 0, stream>>>(out + r0 * D, D, w1 + (size_t)l * D * FF, FF, buf2, FF, 4096, FF, D);
            k_gemm<0><<<dim3(D / 64, 4096 / 64), 256, 0, stream>>>(buf2, FF, w2 + (size_t)l * FF * D, D, buf1 + r0 * D, D, 4096, D, FF);
        }
        k_ln<<<M, 256, 0, stream>>>(out, buf1, nullptr, ln_ffn_g + l * D, ln_ffn_b + l * D, out);
    };
    mlp(0);
    k_gemm<0><<<dim3(D / 64, M / 64), 256, 0, stream>>>(out, D, w_kv, 2 * D, buf1, D, M, D, D);
    k_gemm<0><<<dim3(D / 64, M / 64), 256, 0, stream>>>(out, D, w_kv + D, 2 * D, buf2, D, M, D, D);
    k_gemm<0><<<dim3(D / 64, M / 64), 256, 0, stream>>>(out, D, w_q, D, buf0, D, M, D, D);
    k_rope<<<(unsigned)(((size_t)M * H * 32 + 255) / 256), 256, 0, stream>>>(buf1, D);
    k_rope<<<(unsigned)(((size_t)M * H * 32 + 255) / 256), 256, 0, stream>>>(buf0, D);
    k_kmean<<<dim3(D / 256, B * NBLK), 256, 0, stream>>>(buf1, D, kmean);
    k_moba<<<dim3(M / 4, H), 256, 0, stream>>>(buf0, D, buf1, D, buf2, D, kmean, buf0, D);
    k_gemm<0><<<dim3(D / 64, M / 64), 256, 0, stream>>>(buf0, D, w_o, D, buf1, D, M, D, D);
    k_ln<<<M, 256, 0, stream>>>(out, buf1, nullptr, ln_mix_g + D, ln_mix_b + D, out);
    mlp(1);
}
```
